# Optimizing an MI355X kernel written in HIP

```python
import jax, jax.numpy as jnp
from jax import lax
import numpy as np

D_MODEL = 1024
BATCH = 2
SEQ = 8192
DEPTH = 2

MIX_WIDTH = D_MODEL
ATT_HEADS = 8
ATT_HEAD_DIM = 64
ATT_W = ATT_HEADS * ATT_HEAD_DIM
ROPE_DIM = ATT_HEAD_DIM // 4
ROPE_THETA = 500000.0
MOBA_BLOCK = 256
MOBA_TOPK = 3
Q_BLOCK = 64
MLSTM_HEADS = 4
MLSTM_QK_DIM = 64
MLSTM_V_DIM = 128
ML_QK_W = MLSTM_HEADS * MLSTM_QK_DIM
ML_V_W = MLSTM_HEADS * MLSTM_V_DIM
MLSTM_CHUNK = 64
D_FF = 4 * D_MODEL
EPS = 1e-6
IN_SPLITS = (ATT_W, ATT_W, ATT_W, ML_QK_W, ML_QK_W, ML_V_W, ML_V_W, MLSTM_HEADS, MLSTM_HEADS)
IN_WIDTH = 3 * ATT_W + 2 * ML_QK_W + 2 * ML_V_W + 2 * MLSTM_HEADS

kernel_name = "hybrid_moba_mlstm_parallel_heads"


def rms_norm(x, g):
    xf = x.astype(jnp.float32)
    y = xf * lax.rsqrt(jnp.mean(xf * xf, axis=-1, keepdims=True) + EPS) * g.astype(jnp.float32)
    return y.astype(x.dtype)


def partial_rope(x, positions):
    inv_freq = ROPE_THETA ** (-jnp.arange(0, ROPE_DIM, 2, dtype=jnp.float32) / ROPE_DIM)
    ang = positions.astype(jnp.float32)[:, None, :, None] * inv_freq
    cos = jnp.cos(jnp.concatenate([ang, ang], axis=-1))
    sin = jnp.sin(jnp.concatenate([ang, ang], axis=-1))
    xr, xp = x[..., :ROPE_DIM], x[..., ROPE_DIM:]
    x1, x2 = xr[..., :ROPE_DIM // 2], xr[..., ROPE_DIM // 2:]
    xr = xr * cos + jnp.concatenate([-x2, x1], axis=-1) * sin
    return jnp.concatenate([xr, xp], axis=-1)


def moba_attention(q, k, v):
    B, H, S, Dh = q.shape
    nb = -(-S // MOBA_BLOCK)
    pad = nb * MOBA_BLOCK - S
    kp = jnp.pad(k, ((0, 0), (0, 0), (0, pad), (0, 0)))
    vp = jnp.pad(v, ((0, 0), (0, 0), (0, pad), (0, 0)))
    kb = kp.reshape(B, H, nb, MOBA_BLOCK, Dh)
    vb = vp.reshape(B, H, nb, MOBA_BLOCK, Dh)
    k_mean = jnp.mean(kb, axis=3)
    n_sel = min(MOBA_TOPK, nb)
    scale = Dh ** -0.5
    blk_ids = jnp.arange(nb)
    gather = jax.vmap(jax.vmap(lambda blocks, ids: blocks[ids]))

    def one_block(c):
        q0 = c * Q_BLOCK
        own = q0 // MOBA_BLOCK
        qc = lax.dynamic_slice_in_dim(q, q0, Q_BLOCK, axis=2)
        qpos = q0 + jnp.arange(Q_BLOCK)
        gate = jnp.einsum('bhqd,bhnd->bhqn', qc, k_mean)
        gate = jnp.where(blk_ids < own, gate, -jnp.inf)
        _, sel = lax.top_k(gate, n_sel)
        valid = sel < own
        k_sel = gather(kb, sel)
        v_sel = gather(vb, sel)
        s_sel = jnp.einsum('bhqd,bhqnkd->bhqnk', qc, k_sel) * scale
        s_sel = jnp.where(valid[..., None], s_sel, -jnp.inf).reshape(B, H, Q_BLOCK, n_sel * MOBA_BLOCK)
        k_own = lax.dynamic_slice_in_dim(kp, own * MOBA_BLOCK, MOBA_BLOCK, axis=2)
        v_own = lax.dynamic_slice_in_dim(vp, own * MOBA_BLOCK, MOBA_BLOCK, axis=2)
        kpos = own * MOBA_BLOCK + jnp.arange(MOBA_BLOCK)
        s_own = jnp.einsum('bhqd,bhkd->bhqk', qc, k_own) * scale
        s_own = jnp.where(kpos[None, :] <= qpos[:, None], s_own, -jnp.inf)
        p = jax.nn.softmax(jnp.concatenate([s_sel, s_own], axis=-1).astype(jnp.float32), axis=-1)
        p_sel = p[..., :n_sel * MOBA_BLOCK].reshape(B, H, Q_BLOCK, n_sel, MOBA_BLOCK)
        p_own = p[..., n_sel * MOBA_BLOCK:]
        return (jnp.einsum('bhqnk,bhqnkd->bhqd', p_sel, v_sel)
                + jnp.einsum('bhqk,bhkd->bhqd', p_own, v_own))

    out = lax.map(one_block, jnp.arange(S // Q_BLOCK))
    return jnp.transpose(out, (1, 2, 0, 3, 4)).reshape(B, H, S, Dh)


def mlstm_chunkwise(q, k, v, ig, lf):
    B, H, S, dk = q.shape
    dv = v.shape[-1]
    L = MLSTM_CHUNK
    nc = S // L

    def chunks(a):
        return jnp.moveaxis(a.reshape((B, H, nc, L) + a.shape[3:]), 2, 0)

    causal = jnp.tril(jnp.ones((L, L), dtype=bool))

    def step(carry, xs):
        C, n, m = carry
        qc, kc, vc, ic, fc = xs
        b = jnp.cumsum(fc, axis=-1)
        d = b[..., :, None] - b[..., None, :] + ic[..., None, :]
        d = jnp.where(causal, d, -jnp.inf)
        m_inter = b + m[..., None]
        m_t = jnp.maximum(m_inter, jnp.max(d, axis=-1))
        s = jnp.einsum('bhtd,bhsd->bhts', qc, kc) * jnp.exp(d - m_t[..., None])
        decay = jnp.exp(m_inter - m_t)
        num = (jnp.einsum('bhts,bhsv->bhtv', s, vc)
               + decay[..., None] * jnp.einsum('bhtd,bhdv->bhtv', qc, C))
        den = jnp.sum(s, axis=-1) + decay * jnp.einsum('bhtd,bhd->bht', qc, n)
        h = num / jnp.maximum(jnp.abs(den), jnp.exp(-m_t))[..., None]
        b_last = b[..., -1]
        g = b_last[..., None] - b + ic
        m_new = jnp.maximum(b_last + m, jnp.max(g, axis=-1))
        carry_decay = jnp.exp(b_last + m - m_new)
        wg = jnp.exp(g - m_new[..., None])
        C_new = carry_decay[..., None, None] * C + jnp.einsum('bhs,bhsd,bhsv->bhdv', wg, kc, vc)
        n_new = carry_decay[..., None] * n + jnp.einsum('bhs,bhsd->bhd', wg, kc)
        return (C_new, n_new, m_new), h

    init = (jnp.zeros((B, H, dk, dv), jnp.float32),
            jnp.zeros((B, H, dk), jnp.float32),
            jnp.zeros((B, H), jnp.float32))
    _, h = lax.scan(step, init, (chunks(q), chunks(k), chunks(v), chunks(ig), chunks(lf)))
    return jnp.moveaxis(h, 0, 2).reshape(B, H, S, dv)


def hybrid_layer(x, positions, g_mix_pre, w_in, b_igate, b_fgate, g_mlstm_out, w_out,
                 g_mix_post, g_mlp_pre, w_up, w_down, g_mlp_post):
    B, S, _ = x.shape
    hdn = rms_norm(x, g_mix_pre)
    proj = hdn @ w_in
    aq, ak, av, mq, mk, mv, mo, mi, mf = jnp.split(proj, [int(c) for c in np.cumsum(IN_SPLITS)[:-1]], axis=-1)

    def to_heads(t, nh):
        return t.reshape(B, S, nh, -1).transpose(0, 2, 1, 3).astype(jnp.float32)

    q_a = partial_rope(to_heads(aq, ATT_HEADS), positions)
    k_a = partial_rope(to_heads(ak, ATT_HEADS), positions)
    v_a = to_heads(av, ATT_HEADS)
    att = moba_attention(q_a, k_a, v_a)
    att = att.transpose(0, 2, 1, 3).reshape(B, S, ATT_W)

    q_m = to_heads(mq, MLSTM_HEADS)
    k_m = to_heads(mk, MLSTM_HEADS) * (MLSTM_QK_DIM ** -0.5)
    v_m = to_heads(mv, MLSTM_HEADS)
    ig = (mi.astype(jnp.float32) + b_igate.astype(jnp.float32)).transpose(0, 2, 1)
    lf = jax.nn.log_sigmoid(mf.astype(jnp.float32) + b_fgate.astype(jnp.float32)).transpose(0, 2, 1)
    hm = mlstm_chunkwise(q_m, k_m, v_m, ig, lf)
    hm = hm * lax.rsqrt(jnp.mean(hm * hm, axis=-1, keepdims=True) + EPS)
    hm = hm.transpose(0, 2, 1, 3).reshape(B, S, ML_V_W) * g_mlstm_out.astype(jnp.float32)
    hm = hm * jax.nn.sigmoid(mo.astype(jnp.float32))

    mixed = jnp.concatenate([att, hm], axis=-1).astype(x.dtype)
    x = x + rms_norm(mixed @ w_out, g_mix_post)

    u = rms_norm(x, g_mlp_pre) @ w_up
    u = jnp.square(jax.nn.relu(u))
    x = x + rms_norm(u @ w_down, g_mlp_post)
    return x


def setup_inputs(seed: int = 0) -> dict:
    key = jax.random.key(seed)
    ks = jax.random.split(key, 14)
    f32 = jnp.float32

    def gain(k, n):
        return 1.0 + 0.02 * jax.random.normal(k, (DEPTH, n), f32)

    x = jax.random.normal(ks[0], (BATCH, SEQ, D_MODEL), f32)
    positions = jnp.broadcast_to(jnp.arange(SEQ, dtype=jnp.int32), (BATCH, SEQ))
    g_mix_pre = gain(ks[1], D_MODEL)
    w_in = jax.random.normal(ks[2], (DEPTH, D_MODEL, IN_WIDTH), f32) * D_MODEL ** -0.5
    b_igate = 0.1 * jax.random.normal(ks[3], (DEPTH, MLSTM_HEADS), f32)
    b_fgate = (jnp.linspace(3.0, 6.0, MLSTM_HEADS, dtype=f32)[None, :]
               + 0.1 * jax.random.normal(ks[4], (DEPTH, MLSTM_HEADS), f32))
    g_mlstm_out = gain(ks[5], ML_V_W)
    w_out = jax.random.normal(ks[6], (DEPTH, MIX_WIDTH, D_MODEL), f32) * MIX_WIDTH ** -0.5
    g_mix_post = gain(ks[7], D_MODEL)
    g_mlp_pre = gain(ks[8], D_MODEL)
    w_up = jax.random.normal(ks[9], (DEPTH, D_MODEL, D_FF), f32) * D_MODEL ** -0.5
    w_down = jax.random.normal(ks[10], (DEPTH, D_FF, D_MODEL), f32) * D_FF ** -0.5
    g_mlp_post = gain(ks[11], D_MODEL)
    return {"x": x, "positions": positions, "g_mix_pre": g_mix_pre, "w_in": w_in,
            "b_igate": b_igate, "b_fgate": b_fgate, "g_mlstm_out": g_mlstm_out, "w_out": w_out,
            "g_mix_post": g_mix_post, "g_mlp_pre": g_mlp_pre, "w_up": w_up, "w_down": w_down,
            "g_mlp_post": g_mlp_post}


def reference(x, positions, g_mix_pre, w_in, b_igate, b_fgate, g_mlstm_out, w_out,
              g_mix_post, g_mlp_pre, w_up, w_down, g_mlp_post):
    for layer in range(DEPTH):
        x = hybrid_layer(x, positions, g_mix_pre[layer], w_in[layer], b_igate[layer], b_fgate[layer],
                         g_mlstm_out[layer], w_out[layer], g_mix_post[layer], g_mlp_pre[layer],
                         w_up[layer], w_down[layer], g_mlp_post[layer])
    return x
```

```cpp
#include <hip/hip_runtime.h>
#include <hip/hip_cooperative_groups.h>
#include <cstdio>
#include <cstdint>
namespace cg = cooperative_groups;

#ifndef MK_SINGLE
#define MK_SINGLE 0
#endif

constexpr int NB = 2, S = 8192, M = NB * S, D = 1024, NL = 2;
constexpr int AH = 8, HD = 64, AW = AH * HD;
constexpr int MH = 4, DK = 64, DV = 128;
constexpr int NIN = 3072, NING = 3080, FF = 4096;
constexpr int LCH = 64, NCH = S / LCH;
constexpr int MB = 256, NBLK = S / MB;
constexpr float EPS = 1e-6f;
constexpr float C2 = 0.125f * 1.4426950408889634f;
constexpr int NT = 512, NW = 8;

constexpr size_t KiB = 1024, MiB = 1024 * 1024;
constexpr size_t WS_CTL = 0, CTL_BYTES = 1 * MiB;
constexpr size_t WS_COS = 1 * MiB, WS_SIN = WS_COS + (size_t)M * 8 * 4;
constexpr size_t WS_SMALL = 2 * MiB;
constexpr size_t WS_KMEAN = WS_SMALL;
constexpr size_t WS_IG = WS_KMEAN + (size_t)NB * AH * NBLK * HD * 4;
constexpr size_t WS_LF = WS_IG + (size_t)NB * MH * S * 4;
constexpr size_t WS_BLAST = WS_LF + (size_t)NB * MH * S * 4;
constexpr size_t WS_MLOC = WS_BLAST + (size_t)NB * MH * NCH * 4;
constexpr size_t WS_MPREV = WS_MLOC + (size_t)NB * MH * NCH * 4;
constexpr size_t WS_NLOC = WS_MPREV + (size_t)NB * MH * NCH * 4;
constexpr size_t WS_NPREV = WS_NLOC + (size_t)NB * MH * NCH * DK * 4;
constexpr size_t WS_XCH = WS_NPREV + (size_t)NB * MH * NCH * DK * 4;
constexpr size_t WS_SMALL_END = WS_XCH + 3 * 512 * KiB;
static_assert(WS_SMALL_END <= 5 * MiB, "small region");
constexpr size_t WS_W = 5 * MiB, W_LAYER = 24 * MiB + 256 * KiB;
constexpr size_t W_IN = 0, W_OUT = 6 * MiB + 256 * KiB, W_UP = W_OUT + 2 * MiB, W_DN = W_UP + 8 * MiB;
static_assert((size_t)NING * D * 2 <= W_OUT && W_DN + 8 * MiB == W_LAYER, "weight map");
constexpr size_t WS_BIG = WS_W + NL * W_LAYER;
constexpr size_t B_QA = 0, B_KA = 16 * MiB, B_VA = 32 * MiB, B_MQ = 48 * MiB, B_MK = 56 * MiB, B_MKT = 64 * MiB, B_MVT = 72 * MiB, B_MO = 88 * MiB,
                 B_UT = 104 * MiB, BIG_BYTES = 136 * MiB;
constexpr size_t WS_XN = WS_BIG + BIG_BYTES;
constexpr size_t WS_MIXED = WS_XN + 32 * MiB;
constexpr size_t WS_END = WS_MIXED + 32 * MiB;
static_assert(WS_END <= 256 * MiB, "workspace map");

typedef unsigned short bf16;
typedef short bf16x8 __attribute__((ext_vector_type(8)));
typedef float f32x4 __attribute__((ext_vector_type(4)));
typedef unsigned u32x4 __attribute__((ext_vector_type(4)));
typedef unsigned u32x2 __attribute__((ext_vector_type(2)));
#define LAS __attribute__((address_space(3)))

__device__ __forceinline__ unsigned f2bf(float f) { unsigned u = __builtin_bit_cast(unsigned, f); return (u + 0x7fffu + ((u >> 16) & 1u)) >> 16; }
__device__ __forceinline__ float bf2f(unsigned h) { return __builtin_bit_cast(float, h << 16); }
__device__ __forceinline__ unsigned pk2(float lo, float hi) { return f2bf(lo) | (f2bf(hi) << 16); }
__device__ __forceinline__ float wave_sum(float v) {
#pragma unroll
    for (int o = 1; o < 64; o <<= 1) v += __shfl_xor(v, o);
    return v;
}
__device__ __forceinline__ float wave_max(float v) {
#pragma unroll
    for (int o = 1; o < 64; o <<= 1) v = fmaxf(v, __shfl_xor(v, o));
    return v;
}

struct Args { const void* in[13]; float* out; unsigned char* ws; int ph_lo, ph_hi; };

struct Ctx {
    unsigned char* lds;
    int tid, lane, wave, G, bid;
    const float* x; const int* pos; const float* g_mix_pre; const float* w_in; const float* b_ig; const float* b_fg; const float* g_mo; const float* w_out;
    const float* g_mix_post; const float* g_mlp_pre; const float* w_up; const float* w_dn; const float* g_mlp_post;
    float* out; unsigned char* ws;
};

__device__ __forceinline__ void p0_transpose_item(const float* W, int K, int N, bf16* WT, float* scr, int item, int lane) {
    const int nblk = (N + 31) / 32, kb = item / nblk, nb = item % nblk, k0 = 64 * kb, n0 = 32 * nb;
    const int nn = n0 + (lane & 31);
#pragma unroll 8
    for (int i = 0; i < 32; ++i) { const int kk = 2 * i + (lane >> 5); scr[kk * 33 + (lane & 31)] = nn < N ? W[(size_t)(k0 + kk) * N + nn] : 0.f; }
    __builtin_amdgcn_s_waitcnt(0xc07f); asm volatile("" ::: "memory");
    const int c = lane & 7;
#pragma unroll
    for (int j = 0; j < 4; ++j) { const int n = (lane >> 3) + 8 * j; const float* s = scr + (8 * c) * 33 + n;
        u32x4 o; o.x = pk2(s[0 * 33], s[1 * 33]); o.y = pk2(s[2 * 33], s[3 * 33]); o.z = pk2(s[4 * 33], s[5 * 33]); o.w = pk2(s[6 * 33], s[7 * 33]);
        if (n0 + n < N) *(u32x4*)(WT + (size_t)(n0 + n) * K + k0 + 8 * c) = o; }
    __builtin_amdgcn_s_waitcnt(0xc07f); asm volatile("" ::: "memory");
}
__device__ __forceinline__ void rms_row_to_bf16(const float* xrow, const float* g, bf16* orow, int lane) {
    const f32x4* xr = (const f32x4*)xrow + lane; const f32x4* gr = (const f32x4*)g + lane;
    f32x4 v[4]; float s = 0.f;
#pragma unroll
    for (int j = 0; j < 4; ++j) { v[j] = xr[64 * j]; s += (v[j].x * v[j].x + v[j].y * v[j].y) + (v[j].z * v[j].z + v[j].w * v[j].w); }
    const float rstd = 1.0f / sqrtf(wave_sum(s) * (1.f / D) + EPS);
    u32x2* o8 = (u32x2*)orow + lane;
#pragma unroll
    for (int j = 0; j < 4; ++j) { const f32x4 gg = gr[64 * j]; u32x2 w; w.x = pk2(v[j].x * rstd * gg.x, v[j].y * rstd * gg.y); w.y = pk2(v[j].z * rstd * gg.z, v[j].w * rstd * gg.w); o8[64 * j] = w; }
}
__device__ __forceinline__ void p0_prologue(const Ctx& c) {
    float* scr = (float*)(c.lds + c.wave * 16384);
    const int gw = c.bid * NW + c.wave, NGW = c.G * NW;
    constexpr int I_IN = (D / 64) * ((NING + 31) / 32), I_OUT = (D / 64) * (D / 32), I_UP = (D / 64) * (FF / 32), I_DN = (FF / 64) * (D / 32);
    constexpr int I_LAYER = I_IN + I_OUT + I_UP + I_DN;
    for (int it = gw; it < NL * I_LAYER; it += NGW) {
        const int l = it / I_LAYER; int r = it % I_LAYER;
        unsigned char* wl = c.ws + WS_W + (size_t)l * W_LAYER;
        if (r < I_IN) { p0_transpose_item(c.w_in + (size_t)l * D * NING, D, NING, (bf16*)(wl + W_IN), scr, r, c.lane); continue; } r -= I_IN;
        if (r < I_OUT) { p0_transpose_item(c.w_out + (size_t)l * D * D, D, D, (bf16*)(wl + W_OUT), scr, r, c.lane); continue; } r -= I_OUT;
        if (r < I_UP) { p0_transpose_item(c.w_up + (size_t)l * D * FF, D, FF, (bf16*)(wl + W_UP), scr, r, c.lane); continue; } r -= I_UP;
        p0_transpose_item(c.w_dn + (size_t)l * FF * D, FF, D, (bf16*)(wl + W_DN), scr, r, c.lane);
    }
    bf16* xn = (bf16*)(c.ws + WS_XN);
    for (int m = gw; m < M; m += NGW) rms_row_to_bf16(c.x + (size_t)m * D, c.g_mix_pre, xn + (size_t)m * D, c.lane);
    float* ct = (float*)(c.ws + WS_COS); float* st = (float*)(c.ws + WS_SIN);
    for (int i = c.bid * NT + c.tid; i < M * 8; i += c.G * NT) {
        const int row = i >> 3, j = i & 7;
        const float invf[8] = {1.0f, 0.1939227432012558f, 0.03760603070259094f, 0.007292664609849453f, 0.0014142135623842478f, 0.00027424818836152554f, 5.318296098266728e-05f, 1.0313386155758053e-05f};
        float f = invf[0];
#pragma unroll
        for (int q = 1; q < 8; ++q) f = (j == q) ? invf[q] : f;
        const float ang = (float)c.pos[row] * f;
        double r = (double)ang * 0.15915494309189535; r -= __builtin_floor(r + 0.5);
        const float xr = (float)(r * 6.283185307179586);
        ct[i] = __builtin_cosf(xr); st[i] = __builtin_sinf(xr);
    }
}

template <class Epi>
__device__ __forceinline__ void gemm_naive(const Ctx& c, const bf16* A, int lda, const bf16* Bt, int K, int row0, int nrows, int N, const Epi& epi) {
    float* tile = (float*)(c.lds + c.wave * 16384);
    const int fr = c.lane & 15, fq = c.lane >> 4;
    const int ngrp = N / 512, nit = (nrows / 64) * ngrp;
    for (int it = c.bid; it < nit; it += c.G) {
        const int mt = it / ngrp, nt = (it % ngrp) * 8 + c.wave;
        const int m0 = row0 + mt * 64, n0 = nt * 64;
        f32x4 acc[4][4];
#pragma unroll
        for (int i = 0; i < 4; ++i)
#pragma unroll
            for (int j = 0; j < 4; ++j) acc[i][j] = (f32x4){0.f, 0.f, 0.f, 0.f};
        const bf16* ap = A + (size_t)(m0 + fr) * lda + 8 * fq; const bf16* bp = Bt + (size_t)(n0 + fr) * K + 8 * fq;
        for (int k0 = 0; k0 < K; k0 += 32) {
            bf16x8 a[4], b[4];
#pragma unroll
            for (int i = 0; i < 4; ++i) { a[i] = *(const bf16x8*)(ap + (size_t)(16 * i) * lda + k0); b[i] = *(const bf16x8*)(bp + (size_t)(16 * i) * K + k0); }
#pragma unroll
            for (int i = 0; i < 4; ++i)
#pragma unroll
                for (int j = 0; j < 4; ++j) acc[i][j] = __builtin_amdgcn_mfma_f32_16x16x32_bf16(a[i], b[j], acc[i][j], 0, 0, 0);
        }
#pragma unroll
        for (int i = 0; i < 4; ++i)
#pragma unroll
            for (int j = 0; j < 4; ++j)
#pragma unroll
                for (int r = 0; r < 4; ++r) tile[(16 * i + 4 * fq + r) * 64 + 16 * j + fr] = acc[i][j][r];
        __builtin_amdgcn_s_waitcnt(0xc07f); asm volatile("" ::: "memory");
        for (int r = 0; r < 64; ++r) epi(m0 + r, n0 + c.lane, tile, r, c.lane);
        __builtin_amdgcn_s_waitcnt(0xc07f); asm volatile("" ::: "memory");
    }
}

struct EpiInProj {
    unsigned char* big; const float* cosT; const float* sinT;
    __device__ __forceinline__ void operator()(int row, int col, const float* tile, int r, int lane) const {
        float v = tile[r * 64 + lane];
        if (col < 1024) {
            const int d = col & 63;
            if (d < 16) { const float p = tile[r * 64 + (lane ^ 8)]; const float cs = cosT[row * 8 + (d & 7)], sn = sinT[row * 8 + (d & 7)];
                v = (d < 8) ? v * cs - p * sn : v * cs + p * sn; }
            if (col < 512) ((bf16*)(big + B_QA))[(size_t)row * AW + col] = (bf16)f2bf(v * C2);
            else ((bf16*)(big + B_KA))[(size_t)row * AW + col - 512] = (bf16)f2bf(v);
        } else if (col < 1536) { ((bf16*)(big + B_VA))[(size_t)row * AW + col - 1024] = (bf16)f2bf(v);
        } else if (col < 1792) { ((bf16*)(big + B_MQ))[(size_t)row * 256 + col - 1536] = (bf16)f2bf(v);
        } else if (col < 2048) { const int cc = col - 1792, hh = cc >> 6, dk = cc & 63, b = row >> 13, s = row & (S - 1); const bf16 w = (bf16)f2bf(v * 0.125f);
            ((bf16*)(big + B_MK))[(size_t)row * 256 + cc] = w; ((bf16*)(big + B_MKT))[((size_t)(b * MH + hh) * DK + dk) * S + s] = w;
        } else if (col < 2560) { const int cc = col - 2048, hh = cc >> 7, dv = cc & 127, b = row >> 13, s = row & (S - 1);
            ((bf16*)(big + B_MVT))[((size_t)(b * MH + hh) * DV + dv) * S + s] = (bf16)f2bf(v);
        } else { ((bf16*)(big + B_MO))[(size_t)row * 512 + col - 2560] = (bf16)f2bf(v); }
    }
};
struct EpiF32Out { float* Y; int ldy; int row_off;
    __device__ __forceinline__ void operator()(int row, int col, const float* tile, int r, int lane) const { Y[(size_t)(row - row_off) * ldy + col] = tile[r * 64 + lane]; } };
struct EpiRelu2 { bf16* U;
    __device__ __forceinline__ void operator()(int row, int col, const float* tile, int r, int lane) const { float v = tile[r * 64 + lane]; v = v > 0.f ? v * v : 0.f; U[(size_t)row * FF + col] = (bf16)f2bf(v); } };

__device__ __forceinline__ void kmean_phase(const Ctx& c) {
    const bf16* ka = (const bf16*)(c.ws + WS_BIG + B_KA); float* km = (float*)(c.ws + WS_KMEAN);
    for (int i = c.bid * NT + c.tid; i < NB * AH * NBLK * HD; i += c.G * NT) {
        const int d = i & 63, blk = (i >> 6) & 31, h = (i >> 11) & 7, b = i >> 14;
        const bf16* p = ka + (size_t)(b * S + blk * MB) * AW + h * HD + d; float s = 0.f;
        for (int r = 0; r < MB; ++r) s += bf2f(p[(size_t)r * AW]);
        km[i] = s * (1.f / MB);
    }
}

__device__ __forceinline__ void attn_naive(const Ctx& c) {
    const bf16* qa = (const bf16*)(c.ws + WS_BIG + B_QA); const bf16* ka = (const bf16*)(c.ws + WS_BIG + B_KA); const bf16* va = (const bf16*)(c.ws + WS_BIG + B_VA);
    const float* km = (const float*)(c.ws + WS_KMEAN); bf16* mixed = (bf16*)(c.ws + WS_MIXED);
    float* ps = (float*)(c.lds + c.wave * 8192);
    float* qs = ps + 1024;
    const int lane = c.lane;
    for (int it = c.bid * NW + c.wave; it < NB * AH * S; it += c.G * NW) {
        const int q = it & (S - 1), h = (it >> 13) & 7, b = it >> 16;
        const size_t row = (size_t)b * S + q; const int own = q >> 8;
        qs[lane] = bf2f(qa[row * AW + h * HD + lane]);
        __builtin_amdgcn_s_waitcnt(0xc07f); asm volatile("" ::: "memory");
        float gate = -INFINITY;
        if (lane < own) { const float* kp = km + ((size_t)(b * AH + h) * NBLK + lane) * HD; float s = 0.f; for (int d = 0; d < HD; ++d) s += qs[d] * kp[d]; gate = s; }
        int s0 = 0, s1 = 0, s2 = 0; const int nsel = own < 3 ? own : 3;
#pragma unroll
        for (int i = 0; i < 3; ++i) { if (i < nsel) { const float mx = wave_max(gate); const unsigned long long bal = __ballot(gate == mx); const int w = __builtin_ctzll(bal); if (i == 0) s0 = w; else if (i == 1) s1 = w; else s2 = w; if (lane == w) gate = -INFINITY; } }
        float mx = -INFINITY;
        for (int sl = 0; sl <= nsel; ++sl) {
            const int blk = sl < nsel ? (sl == 0 ? s0 : sl == 1 ? s1 : s2) : own; const int cnt = sl < nsel ? MB : (q & 255) + 1;
            for (int kk = lane; kk < cnt; kk += 64) { const bf16x8* kp = (const bf16x8*)(ka + ((size_t)b * S + blk * MB + kk) * AW + h * HD); float s = 0.f;
#pragma unroll
                for (int j = 0; j < 8; ++j) { const bf16x8 kv = kp[j];
#pragma unroll
                    for (int e = 0; e < 8; ++e) s += qs[8 * j + e] * bf2f((unsigned short)kv[e]); }
                ps[sl * 256 + kk] = s; mx = fmaxf(mx, s); }
        }
        mx = wave_max(mx);
        __builtin_amdgcn_s_waitcnt(0xc07f); asm volatile("" ::: "memory");
        float l = 0.f, o = 0.f;
        for (int sl = 0; sl <= nsel; ++sl) {
            const int blk = sl < nsel ? (sl == 0 ? s0 : sl == 1 ? s1 : s2) : own; const int cnt = sl < nsel ? MB : (q & 255) + 1;
            const bf16* vp = va + ((size_t)b * S + blk * MB) * AW + h * HD + lane;
            for (int kk = 0; kk < cnt; ++kk) { const float p = exp2f(ps[sl * 256 + kk] - mx); l += p; o += p * bf2f(vp[(size_t)kk * AW]); }
        }
        mixed[row * D + h * HD + lane] = (bf16)f2bf(o / l);
        __builtin_amdgcn_s_waitcnt(0xc07f); asm volatile("" ::: "memory");
    }
}

__device__ __forceinline__ void mlstm_a(const Ctx& c, int layer) {
    const bf16* xn = (const bf16*)(c.ws + WS_XN); const bf16* WinT = (const bf16*)(c.ws + WS_W + (size_t)layer * W_LAYER + W_IN);
    const bf16* mkT = (const bf16*)(c.ws + WS_BIG + B_MKT); const bf16* mvT = (const bf16*)(c.ws + WS_BIG + B_MVT);
    float* igG = (float*)(c.ws + WS_IG); float* lfG = (float*)(c.ws + WS_LF); float* blast = (float*)(c.ws + WS_BLAST); float* mloc = (float*)(c.ws + WS_MLOC);
    float* nloc = (float*)(c.ws + WS_NLOC); float* UT = (float*)(c.ws + WS_BIG + B_UT);
    float* igs = (float*)c.lds; float* lfs = igs + 64; float* wgs = lfs + 64;
    for (int it = c.bid; it < NB * MH * NCH; it += c.G) {
        const int ch = it & (NCH - 1), bh = it >> 7, h = bh & 3, b = bh >> 2;
        for (int p = c.wave * 16; p < c.wave * 16 + 16; ++p) {
            const int t = p & 63, which = p >> 6;
            const bf16x8* xr = (const bf16x8*)(xn + ((size_t)b * S + ch * LCH + t) * D) + 2 * c.lane; const bf16x8* wr = (const bf16x8*)(WinT + (size_t)(NIN + which * 4 + h) * D) + 2 * c.lane;
            float s = 0.f;
#pragma unroll
            for (int j = 0; j < 2; ++j) { const bf16x8 xv = xr[j], wv = wr[j];
#pragma unroll
                for (int e = 0; e < 8; ++e) s += bf2f((unsigned short)xv[e]) * bf2f((unsigned short)wv[e]); }
            s = wave_sum(s);
            if (c.lane == 0) { if (which == 0) igs[t] = s + c.b_ig[layer * MH + h]; else { const float f = s + c.b_fg[layer * MH + h]; lfs[t] = fminf(f, 0.f) - log1pf(expf(-fabsf(f))); } }
        }
        __syncthreads();
        if (c.tid < 64) { igG[(size_t)bh * S + ch * LCH + c.tid] = igs[c.tid]; lfG[(size_t)bh * S + ch * LCH + c.tid] = lfs[c.tid]; }
        if (c.tid == 0) {
            float bl = 0.f; for (int s = 0; s < LCH; ++s) bl += lfs[s];
            float run = 0.f, mx = -INFINITY;
            for (int s = 0; s < LCH; ++s) { run += lfs[s]; const float g = bl - run + igs[s]; wgs[s] = g; mx = fmaxf(mx, g); }
            for (int s = 0; s < LCH; ++s) wgs[s] = expf(wgs[s] - mx);
            blast[it] = bl; mloc[it] = mx;
        }
        __syncthreads();
        for (int o = c.tid; o < DV * DK; o += NT) {
            const int dv = o >> 6, dk = o & 63;
            const bf16* vp = mvT + ((size_t)bh * DV + dv) * S + ch * LCH; const bf16* kp = mkT + ((size_t)bh * DK + dk) * S + ch * LCH; float s = 0.f;
            for (int t = 0; t < LCH; ++t) s += wgs[t] * bf2f(vp[t]) * bf2f(kp[t]);
            UT[((size_t)it * DV + dv) * DK + dk] = s;
        }
        if (c.tid < DK) { const bf16* kp = mkT + ((size_t)bh * DK + c.tid) * S + ch * LCH; float s = 0.f; for (int t = 0; t < LCH; ++t) s += wgs[t] * bf2f(kp[t]); nloc[(size_t)it * DK + c.tid] = s; }
        __syncthreads();
    }
}
__device__ __forceinline__ void mlstm_b(const Ctx& c) {
    const float* blast = (const float*)(c.ws + WS_BLAST); const float* mloc = (const float*)(c.ws + WS_MLOC); const float* nloc = (const float*)(c.ws + WS_NLOC);
    const float* UT = (const float*)(c.ws + WS_BIG + B_UT);
    float* mprev = (float*)(c.ws + WS_MPREV); float* nprev = (float*)(c.ws + WS_NPREV); bf16* CT = (bf16*)(c.ws + WS_XN);
    constexpr int EPB = DV * DK + DK;
    for (int e = c.bid * NT + c.tid; e < NB * MH * EPB; e += c.G * NT) {
        const int bh = e / EPB, r = e % EPB; const bool isC = r < DV * DK;
        float m = 0.f, val = 0.f;
#pragma unroll 4
        for (int ch = 0; ch < NCH; ++ch) {
            const int ci = bh * NCH + ch;
            const float u = isC ? UT[(size_t)ci * (DV * DK) + r] : nloc[(size_t)ci * DK + (r - DV * DK)];
            if (isC) CT[(size_t)ci * (DV * DK) + r] = (bf16)f2bf(val); else nprev[(size_t)ci * DK + (r - DV * DK)] = val;
            if (r == 0) mprev[ci] = m;
            const float bl = blast[ci], ml = mloc[ci];
            const float mn = fmaxf(bl + m, ml);
            val = expf(bl + m - mn) * val + expf(ml - mn) * u; m = mn;
        }
    }
}
__device__ __forceinline__ void mlstm_c_naive(const Ctx& c, int layer) {
    const bf16* mq = (const bf16*)(c.ws + WS_BIG + B_MQ); const bf16* mk = (const bf16*)(c.ws + WS_BIG + B_MK); const bf16* mvT = (const bf16*)(c.ws + WS_BIG + B_MVT);
    const bf16* mo = (const bf16*)(c.ws + WS_BIG + B_MO); const bf16* CT = (const bf16*)(c.ws + WS_XN);
    const float* igG = (const float*)(c.ws + WS_IG); const float* lfG = (const float*)(c.ws + WS_LF); const float* mprev = (const float*)(c.ws + WS_MPREV); const float* nprev = (const float*)(c.ws + WS_NPREV);
    bf16* mixed = (bf16*)(c.ws + WS_MIXED);
    float* qs = (float*)c.lds; float* ks = qs + 4096; float* Ss = ks + 4096; float* hs = Ss + 64 * 65; float* as = hs + 64 * 128; float* bs = as + 64; float* mt = bs + 64; float* dec = mt + 64; float* inv = dec + 64; float* rs = inv + 64;
    for (int it = c.bid; it < NB * MH * NCH; it += c.G) {
        const int ch = it & (NCH - 1), bh = it >> 7, h = bh & 3, b = bh >> 2;
        const size_t row0 = (size_t)b * S + ch * LCH;
        for (int i = c.tid; i < 4096; i += NT) { const int t = i >> 6, d = i & 63; qs[i] = bf2f(mq[(row0 + t) * 256 + h * DK + d]); ks[i] = bf2f(mk[(row0 + t) * 256 + h * DK + d]); }
        if (c.tid == 0) { float run = 0.f; for (int s = 0; s < LCH; ++s) { run += lfG[(size_t)bh * S + ch * LCH + s]; bs[s] = run; as[s] = igG[(size_t)bh * S + ch * LCH + s] - run; } }
        __syncthreads();
        const float mp = mprev[it];
        if (c.tid < 64) { float am = -INFINITY; for (int s = 0; s <= c.tid; ++s) am = fmaxf(am, as[s]); const float bt = bs[c.tid]; const float m = fmaxf(bt + mp, bt + am); mt[c.tid] = m; dec[c.tid] = expf(bt + mp - m); }
        __syncthreads();
        for (int i = c.tid; i < 4096; i += NT) { const int t = i >> 6, s = i & 63; float v = 0.f;
            if (s <= t) { float dt = 0.f; for (int d = 0; d < 64; ++d) dt += qs[t * 64 + d] * ks[s * 64 + d]; v = dt * expf(bs[t] + as[s] - mt[t]); }
            Ss[t * 65 + s] = v; }
        __syncthreads();
        if (c.tid < 64) { const int t = c.tid; float dn = 0.f; for (int s = 0; s < 64; ++s) dn += Ss[t * 65 + s]; float qn = 0.f; for (int d = 0; d < 64; ++d) qn += qs[t * 64 + d] * nprev[(size_t)it * DK + d];
            dn += dec[t] * qn; inv[t] = 1.0f / fmaxf(fabsf(dn), expf(-mt[t])); }
        __syncthreads();
        for (int i = c.tid; i < 64 * 128; i += NT) { const int t = i >> 7, dv = i & 127; float a = 0.f, cc = 0.f;
            const bf16* vp = mvT + ((size_t)bh * DV + dv) * S + ch * LCH; const bf16* cp = CT + (size_t)it * (DV * DK) + dv * DK;
            for (int s = 0; s < 64; ++s) a += Ss[t * 65 + s] * bf2f(vp[s]);
            for (int d = 0; d < 64; ++d) cc += qs[t * 64 + d] * bf2f(cp[d]);
            hs[i] = (a + dec[t] * cc) * inv[t]; }
        __syncthreads();
        if (c.tid < 64) { float s2 = 0.f; for (int dv = 0; dv < 128; ++dv) { const float v = hs[c.tid * 128 + dv]; s2 += v * v; } rs[c.tid] = 1.0f / sqrtf(s2 * (1.f / 128.f) + EPS); }
        __syncthreads();
        for (int i = c.tid; i < 64 * 128; i += NT) { const int t = i >> 7, dv = i & 127; const float g = c.g_mo[layer * 512 + h * DV + dv]; const float o = bf2f(mo[(row0 + t) * 512 + h * DV + dv]);
            mixed[(row0 + t) * D + 512 + h * DV + dv] = (bf16)f2bf(hs[i] * rs[t] * g / (1.0f + expf(-o))); }
        __syncthreads();
    }
}

__device__ __forceinline__ void rownorm_phase(const Ctx& c, const float* Y, int row0, int nrows, const float* base, const float* g1, const float* g2) {
    bf16* xn = (bf16*)(c.ws + WS_XN);
    for (int m = c.bid * NW + c.wave; m < nrows; m += c.G * NW) {
        const int row = row0 + m;
        const f32x4* yr = (const f32x4*)(Y + (size_t)m * D) + c.lane; const f32x4* br = (const f32x4*)(base + (size_t)row * D) + c.lane; const f32x4* g1r = (const f32x4*)g1 + c.lane;
        f32x4 v[4]; float s = 0.f;
#pragma unroll
        for (int j = 0; j < 4; ++j) { v[j] = yr[64 * j]; s += (v[j].x * v[j].x + v[j].y * v[j].y) + (v[j].z * v[j].z + v[j].w * v[j].w); }
        const float rstd = 1.0f / sqrtf(wave_sum(s) * (1.f / D) + EPS); float s1 = 0.f;
#pragma unroll
        for (int j = 0; j < 4; ++j) { v[j] = br[64 * j] + v[j] * rstd * g1r[64 * j]; s1 += (v[j].x * v[j].x + v[j].y * v[j].y) + (v[j].z * v[j].z + v[j].w * v[j].w); }
        f32x4* orow = (f32x4*)(c.out + (size_t)row * D) + c.lane;
#pragma unroll
        for (int j = 0; j < 4; ++j) orow[64 * j] = v[j];
        if (g2) { const float rstd1 = 1.0f / sqrtf(wave_sum(s1) * (1.f / D) + EPS); const f32x4* g2r = (const f32x4*)g2 + c.lane; u32x2* o8 = (u32x2*)(xn + (size_t)row * D) + c.lane;
#pragma unroll
            for (int j = 0; j < 4; ++j) { const f32x4 gg = g2r[64 * j]; u32x2 w; w.x = pk2(v[j].x * rstd1 * gg.x, v[j].y * rstd1 * gg.y); w.y = pk2(v[j].z * rstd1 * gg.z, v[j].w * rstd1 * gg.w); o8[64 * j] = w; } }
    }
}

constexpr int PH_PER_LAYER = 12, N_PHASES = 1 + NL * PH_PER_LAYER;
constexpr int LDS_BYTES = 147456;

__global__ void __launch_bounds__(NT, 2) fwd_kernel(Args args) {
    extern __shared__ __attribute__((aligned(16))) unsigned char lds[];
    Ctx c;
    c.lds = lds; c.tid = threadIdx.x; c.lane = c.tid & 63; c.wave = __builtin_amdgcn_readfirstlane(c.tid >> 6); c.G = gridDim.x; c.bid = blockIdx.x;
    c.x = (const float*)args.in[0]; c.pos = (const int*)args.in[1]; c.g_mix_pre = (const float*)args.in[2]; c.w_in = (const float*)args.in[3]; c.b_ig = (const float*)args.in[4];
    c.b_fg = (const float*)args.in[5]; c.g_mo = (const float*)args.in[6]; c.w_out = (const float*)args.in[7]; c.g_mix_post = (const float*)args.in[8]; c.g_mlp_pre = (const float*)args.in[9];
    c.w_up = (const float*)args.in[10]; c.w_dn = (const float*)args.in[11]; c.g_mlp_post = (const float*)args.in[12]; c.out = args.out; c.ws = args.ws;
    unsigned char* big = c.ws + WS_BIG;
    for (int ph = args.ph_lo; ph < args.ph_hi; ++ph) {
        if (ph == 0) p0_prologue(c);
        else {
            const int l = (ph - 1) / PH_PER_LAYER, p = (ph - 1) % PH_PER_LAYER;
            unsigned char* wl = c.ws + WS_W + (size_t)l * W_LAYER;
            const float* base = l == 0 ? c.x : c.out;
            switch (p) {
            case 0: { EpiInProj e{big, (const float*)(c.ws + WS_COS), (const float*)(c.ws + WS_SIN)}; gemm_naive(c, (const bf16*)(c.ws + WS_XN), D, (const bf16*)(wl + W_IN), D, 0, M, NIN, e); } break;
            case 1: kmean_phase(c); break;
            case 2: mlstm_a(c, l); break;
            case 3: mlstm_b(c); break;
            case 4: attn_naive(c); __syncthreads(); mlstm_c_naive(c, l); break;
            case 5: { EpiF32Out e{(float*)big, D, 0}; gemm_naive(c, (const bf16*)(c.ws + WS_MIXED), D, (const bf16*)(wl + W_OUT), D, 0, M, D, e); } break;
            case 6: rownorm_phase(c, (const float*)big, 0, M, base, c.g_mix_post + l * D, c.g_mlp_pre + l * D); break;
            case 7: { EpiRelu2 e{(bf16*)big}; gemm_naive(c, (const bf16*)(c.ws + WS_XN), D, (const bf16*)(wl + W_UP), D, 0, M, FF, e); } break;
            case 8: case 10: { const int r0 = (p == 8) ? 0 : M / 2; EpiF32Out e{(float*)(c.ws + WS_MIXED), D, r0}; gemm_naive(c, (const bf16*)big, FF, (const bf16*)(wl + W_DN), FF, r0, M / 2, D, e); } break;
            case 9: case 11: { const int r0 = (p == 9) ? 0 : M / 2; rownorm_phase(c, (const float*)(c.ws + WS_MIXED), r0, M / 2, c.out, c.g_mlp_post + l * D, (l + 1 < NL) ? c.g_mix_pre + (l + 1) * D : nullptr); } break;
            }
        }
        if (ph + 1 < args.ph_hi) { cg::this_grid().sync(); }
    }
}

extern "C" void kernel_launch(void* const* d_in, const int* in_sizes, int n_in, void* d_out, int out_size, void* d_ws, size_t ws_size, hipStream_t stream) {
    static int grid = 0;
    if (grid == 0) {
        if (n_in != 13 || out_size != M * D || ws_size < WS_END) { fprintf(stderr, "kernel_launch: unexpected shapes (n_in %d out %d ws %zu)\n", n_in, out_size, ws_size); grid = -1; return; }
        int dev = 0, cus = 0, per_cu = 0;
        (void)hipGetDevice(&dev); (void)hipDeviceGetAttribute(&cus, hipDeviceAttributeMultiprocessorCount, dev);
        (void)hipFuncSetAttribute((const void*)fwd_kernel, hipFuncAttributeMaxDynamicSharedMemorySize, LDS_BYTES);
        (void)hipOccupancyMaxActiveBlocksPerMultiprocessor(&per_cu, (const void*)fwd_kernel, NT, LDS_BYTES);
        if (per_cu < 1) { fprintf(stderr, "kernel_launch: occupancy query says %d blocks per CU\n", per_cu); }
        (void)hipGetLastError();
        grid = cus > 0 ? cus : 256;
    }
    if (grid < 0) return;
    (void)hipMemsetAsync((char*)d_ws + WS_CTL, 0, CTL_BYTES, stream);
    Args a{};
    for (int i = 0; i < 13; ++i) a.in[i] = d_in[i];
    a.out = (float*)d_out; a.ws = (unsigned char*)d_ws;
#if MK_SINGLE
    a.ph_lo = 0; a.ph_hi = N_PHASES;
    void* kargs[] = {&a};
    hipError_t e = hipLaunchCooperativeKernel((const void*)fwd_kernel, dim3(grid), dim3(NT), kargs, LDS_BYTES, stream);
    if (e != hipSuccess) fprintf(stderr, "cooperative launch failed: %s (grid %d)\n", hipGetErrorString(e), grid);
#else
    for (int ph = 0; ph < N_PHASES; ++ph) { a.ph_lo = ph; a.ph_hi = ph + 1; hipLaunchKernelGGL(fwd_kernel, dim3(grid), dim3(NT), LDS_BYTES, stream, a); }
#endif
}
```

```cpp
#include <hip/hip_runtime.h>
#include <hip/hip_cooperative_groups.h>
#include <cstdio>
#include <cstdint>
namespace cg = cooperative_groups;

#ifndef MK_SINGLE
#define MK_SINGLE 1
#endif

constexpr int NB = 2, S = 8192, M = NB * S, D = 1024, NL = 2;
constexpr int AH = 8, HD = 64, AW = AH * HD;
constexpr int MH = 4, DK = 64, DV = 128;
constexpr int NIN = 3072, NING = 3080, FF = 4096;
constexpr int LCH = 64, NCH = S / LCH;
constexpr int MB = 256, NBLK = S / MB;
constexpr float EPS = 1e-6f;
constexpr float C2 = 0.125f * 1.4426950408889634f;
constexpr int NT = 512, NW = 8;

constexpr size_t KiB = 1024, MiB = 1024 * 1024;
constexpr size_t WS_CTL = 0, CTL_BYTES = 1 * MiB;
constexpr size_t WS_COS = 1 * MiB, WS_SIN = WS_COS + (size_t)M * 8 * 4;
constexpr size_t WS_SMALL = 2 * MiB;
constexpr size_t WS_KMEAN = WS_SMALL;
constexpr size_t WS_IG = WS_KMEAN + (size_t)NB * AH * NBLK * HD * 4;
constexpr size_t WS_LF = WS_IG + (size_t)NB * MH * S * 4;
constexpr size_t WS_BLAST = WS_LF + (size_t)NB * MH * S * 4;
constexpr size_t WS_MLOC = WS_BLAST + (size_t)NB * MH * NCH * 4;
constexpr size_t WS_MPREV = WS_MLOC + (size_t)NB * MH * NCH * 4;
constexpr size_t WS_NLOC = WS_MPREV + (size_t)NB * MH * NCH * 4;
constexpr size_t WS_NPREV = WS_NLOC + (size_t)NB * MH * NCH * DK * 4;
constexpr size_t WS_XCH = WS_NPREV + (size_t)NB * MH * NCH * DK * 4;
constexpr size_t WS_SMALL_END = WS_XCH + 3 * 512 * KiB;
static_assert(WS_SMALL_END <= 5 * MiB, "small region");
constexpr size_t WS_W = 5 * MiB, W_LAYER = 24 * MiB + 256 * KiB;
constexpr size_t W_IN = 0, W_OUT = 6 * MiB + 256 * KiB, W_UP = W_OUT + 2 * MiB, W_DN = W_UP + 8 * MiB;
static_assert((size_t)NING * D * 2 <= W_OUT && W_DN + 8 * MiB == W_LAYER, "weight map");
constexpr size_t WS_BIG = WS_W + NL * W_LAYER;
constexpr size_t B_QA = 0, B_KA = 16 * MiB, B_VA = 32 * MiB, B_MQ = 48 * MiB, B_MK = 56 * MiB, B_MKT = 64 * MiB, B_MVT = 72 * MiB, B_MO = 88 * MiB,
                 B_UT = 104 * MiB, BIG_BYTES = 136 * MiB;
constexpr size_t WS_XN = WS_BIG + BIG_BYTES;
constexpr size_t WS_MIXED = WS_XN + 32 * MiB;
constexpr size_t WS_END = WS_MIXED + 32 * MiB;
static_assert(WS_END <= 256 * MiB, "workspace map");

typedef unsigned short bf16;
typedef short bf16x8 __attribute__((ext_vector_type(8)));
typedef float f32x4 __attribute__((ext_vector_type(4)));
typedef unsigned u32x4 __attribute__((ext_vector_type(4)));
typedef unsigned u32x2 __attribute__((ext_vector_type(2)));
#define LAS __attribute__((address_space(3)))

__device__ __forceinline__ unsigned f2bf(float f) { unsigned u = __builtin_bit_cast(unsigned, f); return (u + 0x7fffu + ((u >> 16) & 1u)) >> 16; }
__device__ __forceinline__ float bf2f(unsigned h) { return __builtin_bit_cast(float, h << 16); }
__device__ __forceinline__ unsigned pk2(float lo, float hi) { return f2bf(lo) | (f2bf(hi) << 16); }
__device__ __forceinline__ float wave_sum(float v) {
#pragma unroll
    for (int o = 1; o < 64; o <<= 1) v += __shfl_xor(v, o);
    return v;
}
__device__ __forceinline__ float wave_max(float v) {
#pragma unroll
    for (int o = 1; o < 64; o <<= 1) v = fmaxf(v, __shfl_xor(v, o));
    return v;
}

struct Args { const void* in[13]; float* out; unsigned char* ws; int ph_lo, ph_hi; };

struct Ctx {
    unsigned char* lds;
    int tid, lane, wave, G, bid;
    const float* x; const int* pos; const float* g_mix_pre; const float* w_in; const float* b_ig; const float* b_fg; const float* g_mo; const float* w_out;
    const float* g_mix_post; const float* g_mlp_pre; const float* w_up; const float* w_dn; const float* g_mlp_post;
    float* out; unsigned char* ws;
};

__device__ __forceinline__ void p0_transpose_item(const float* W, int K, int N, bf16* WT, float* scr, int item, int lane) {
    const int nblk = (N + 31) / 32, kb = item / nblk, nb = item % nblk, k0 = 64 * kb, n0 = 32 * nb;
    const int nn = n0 + (lane & 31);
#pragma unroll 8
    for (int i = 0; i < 32; ++i) { const int kk = 2 * i + (lane >> 5); scr[kk * 33 + (lane & 31)] = nn < N ? W[(size_t)(k0 + kk) * N + nn] : 0.f; }
    __builtin_amdgcn_s_waitcnt(0xc07f); asm volatile("" ::: "memory");
    const int c = lane & 7;
#pragma unroll
    for (int j = 0; j < 4; ++j) { const int n = (lane >> 3) + 8 * j; const float* s = scr + (8 * c) * 33 + n;
        u32x4 o; o.x = pk2(s[0 * 33], s[1 * 33]); o.y = pk2(s[2 * 33], s[3 * 33]); o.z = pk2(s[4 * 33], s[5 * 33]); o.w = pk2(s[6 * 33], s[7 * 33]);
        if (n0 + n < N) *(u32x4*)(WT + (size_t)(n0 + n) * K + k0 + 8 * c) = o; }
    __builtin_amdgcn_s_waitcnt(0xc07f); asm volatile("" ::: "memory");
}
__device__ __forceinline__ void rms_row_to_bf16(const float* xrow, const float* g, bf16* orow, int lane) {
    const f32x4* xr = (const f32x4*)xrow + lane; const f32x4* gr = (const f32x4*)g + lane;
    f32x4 v[4]; float s = 0.f;
#pragma unroll
    for (int j = 0; j < 4; ++j) { v[j] = xr[64 * j]; s += (v[j].x * v[j].x + v[j].y * v[j].y) + (v[j].z * v[j].z + v[j].w * v[j].w); }
    const float rstd = 1.0f / sqrtf(wave_sum(s) * (1.f / D) + EPS);
    u32x2* o8 = (u32x2*)orow + lane;
#pragma unroll
    for (int j = 0; j < 4; ++j) { const f32x4 gg = gr[64 * j]; u32x2 w; w.x = pk2(v[j].x * rstd * gg.x, v[j].y * rstd * gg.y); w.y = pk2(v[j].z * rstd * gg.z, v[j].w * rstd * gg.w); o8[64 * j] = w; }
}
__device__ __forceinline__ void p0_prologue(const Ctx& c) {
    float* scr = (float*)(c.lds + c.wave * 16384);
    const int gw = c.bid * NW + c.wave, NGW = c.G * NW;
    constexpr int I_IN = (D / 64) * ((NING + 31) / 32), I_OUT = (D / 64) * (D / 32), I_UP = (D / 64) * (FF / 32), I_DN = (FF / 64) * (D / 32);
    constexpr int I_LAYER = I_IN + I_OUT + I_UP + I_DN;
    for (int it = gw; it < NL * I_LAYER; it += NGW) {
        const int l = it / I_LAYER; int r = it % I_LAYER;
        unsigned char* wl = c.ws + WS_W + (size_t)l * W_LAYER;
        if (r < I_IN) { p0_transpose_item(c.w_in + (size_t)l * D * NING, D, NING, (bf16*)(wl + W_IN), scr, r, c.lane); continue; } r -= I_IN;
        if (r < I_OUT) { p0_transpose_item(c.w_out + (size_t)l * D * D, D, D, (bf16*)(wl + W_OUT), scr, r, c.lane); continue; } r -= I_OUT;
        if (r < I_UP) { p0_transpose_item(c.w_up + (size_t)l * D * FF, D, FF, (bf16*)(wl + W_UP), scr, r, c.lane); continue; } r -= I_UP;
        p0_transpose_item(c.w_dn + (size_t)l * FF * D, FF, D, (bf16*)(wl + W_DN), scr, r, c.lane);
    }
    bf16* xn = (bf16*)(c.ws + WS_XN);
    for (int m = gw; m < M; m += NGW) rms_row_to_bf16(c.x + (size_t)m * D, c.g_mix_pre, xn + (size_t)m * D, c.lane);
    float* ct = (float*)(c.ws + WS_COS); float* st = (float*)(c.ws + WS_SIN);
    for (int i = c.bid * NT + c.tid; i < M * 8; i += c.G * NT) {
        const int row = i >> 3, j = i & 7;
        const float invf[8] = {1.0f, 0.1939227432012558f, 0.03760603070259094f, 0.007292664609849453f, 0.0014142135623842478f, 0.00027424818836152554f, 5.318296098266728e-05f, 1.0313386155758053e-05f};
        float f = invf[0];
#pragma unroll
        for (int q = 1; q < 8; ++q) f = (j == q) ? invf[q] : f;
        const float ang = (float)c.pos[row] * f;
        double r = (double)ang * 0.15915494309189535; r -= __builtin_floor(r + 0.5);
        const float xr = (float)(r * 6.283185307179586);
        ct[i] = __builtin_cosf(xr); st[i] = __builtin_sinf(xr);
    }
}

template <class Epi>
__device__ __forceinline__ void gemm_naive(const Ctx& c, const bf16* A, int lda, const bf16* Bt, int K, int row0, int nrows, int N, const Epi& epi) {
    float* tile = (float*)(c.lds + c.wave * 16384);
    const int fr = c.lane & 15, fq = c.lane >> 4;
    const int ngrp = N / 512, nit = (nrows / 64) * ngrp;
    for (int it = c.bid; it < nit; it += c.G) {
        const int mt = it / ngrp, nt = (it % ngrp) * 8 + c.wave;
        const int m0 = row0 + mt * 64, n0 = nt * 64;
        f32x4 acc[4][4];
#pragma unroll
        for (int i = 0; i < 4; ++i)
#pragma unroll
            for (int j = 0; j < 4; ++j) acc[i][j] = (f32x4){0.f, 0.f, 0.f, 0.f};
        const bf16* ap = A + (size_t)(m0 + fr) * lda + 8 * fq; const bf16* bp = Bt + (size_t)(n0 + fr) * K + 8 * fq;
        for (int k0 = 0; k0 < K; k0 += 32) {
            bf16x8 a[4], b[4];
#pragma unroll
            for (int i = 0; i < 4; ++i) { a[i] = *(const bf16x8*)(ap + (size_t)(16 * i) * lda + k0); b[i] = *(const bf16x8*)(bp + (size_t)(16 * i) * K + k0); }
#pragma unroll
            for (int i = 0; i < 4; ++i)
#pragma unroll
                for (int j = 0; j < 4; ++j) acc[i][j] = __builtin_amdgcn_mfma_f32_16x16x32_bf16(a[i], b[j], acc[i][j], 0, 0, 0);
        }
#pragma unroll
        for (int i = 0; i < 4; ++i)
#pragma unroll
            for (int j = 0; j < 4; ++j)
#pragma unroll
                for (int r = 0; r < 4; ++r) tile[(16 * i + 4 * fq + r) * 64 + 16 * j + fr] = acc[i][j][r];
        __builtin_amdgcn_s_waitcnt(0xc07f); asm volatile("" ::: "memory");
        for (int r = 0; r < 64; ++r) epi(m0 + r, n0 + c.lane, tile, r, c.lane);
        __builtin_amdgcn_s_waitcnt(0xc07f); asm volatile("" ::: "memory");
    }
}

struct EpiInProj {
    unsigned char* big; const float* cosT; const float* sinT;
    __device__ __forceinline__ void operator()(int row, int col, const float* tile, int r, int lane) const {
        float v = tile[r * 64 + lane];
        if (col < 1024) {
            const int d = col & 63;
            if (d < 16) { const float p = tile[r * 64 + (lane ^ 8)]; const float cs = cosT[row * 8 + (d & 7)], sn = sinT[row * 8 + (d & 7)];
                v = (d < 8) ? v * cs - p * sn : v * cs + p * sn; }
            if (col < 512) ((bf16*)(big + B_QA))[(size_t)row * AW + col] = (bf16)f2bf(v * C2);
            else ((bf16*)(big + B_KA))[(size_t)row * AW + col - 512] = (bf16)f2bf(v);
        } else if (col < 1536) { ((bf16*)(big + B_VA))[(size_t)row * AW + col - 1024] = (bf16)f2bf(v);
        } else if (col < 1792) { ((bf16*)(big + B_MQ))[(size_t)row * 256 + col - 1536] = (bf16)f2bf(v);
        } else if (col < 2048) { const int cc = col - 1792, hh = cc >> 6, dk = cc & 63, b = row >> 13, s = row & (S - 1); const bf16 w = (bf16)f2bf(v * 0.125f);
            ((bf16*)(big + B_MK))[(size_t)row * 256 + cc] = w; ((bf16*)(big + B_MKT))[((size_t)(b * MH + hh) * DK + dk) * S + s] = w;
        } else if (col < 2560) { const int cc = col - 2048, hh = cc >> 7, dv = cc & 127, b = row >> 13, s = row & (S - 1);
            ((bf16*)(big + B_MVT))[((size_t)(b * MH + hh) * DV + dv) * S + s] = (bf16)f2bf(v);
        } else { ((bf16*)(big + B_MO))[(size_t)row * 512 + col - 2560] = (bf16)f2bf(v); }
    }
};
struct EpiF32Out { float* Y; int ldy; int row_off;
    __device__ __forceinline__ void operator()(int row, int col, const float* tile, int r, int lane) const { Y[(size_t)(row - row_off) * ldy + col] = tile[r * 64 + lane]; } };
struct EpiRelu2 { bf16* U;
    __device__ __forceinline__ void operator()(int row, int col, const float* tile, int r, int lane) const { float v = tile[r * 64 + lane]; v = v > 0.f ? v * v : 0.f; U[(size_t)row * FF + col] = (bf16)f2bf(v); } };

__device__ __forceinline__ void kmean_phase(const Ctx& c) {
    const bf16* ka = (const bf16*)(c.ws + WS_BIG + B_KA); float* km = (float*)(c.ws + WS_KMEAN);
    for (int i = c.bid * NT + c.tid; i < NB * AH * NBLK * HD; i += c.G * NT) {
        const int d = i & 63, blk = (i >> 6) & 31, h = (i >> 11) & 7, b = i >> 14;
        const bf16* p = ka + (size_t)(b * S + blk * MB) * AW + h * HD + d; float s = 0.f;
        for (int r = 0; r < MB; ++r) s += bf2f(p[(size_t)r * AW]);
        km[i] = s * (1.f / MB);
    }
}

__device__ __forceinline__ void attn_naive(const Ctx& c) {
    const bf16* qa = (const bf16*)(c.ws + WS_BIG + B_QA); const bf16* ka = (const bf16*)(c.ws + WS_BIG + B_KA); const bf16* va = (const bf16*)(c.ws + WS_BIG + B_VA);
    const float* km = (const float*)(c.ws + WS_KMEAN); bf16* mixed = (bf16*)(c.ws + WS_MIXED);
    float* ps = (float*)(c.lds + c.wave * 8192);
    float* qs = ps + 1024;
    const int lane = c.lane;
    for (int it = c.bid * NW + c.wave; it < NB * AH * S; it += c.G * NW) {
        const int q = it & (S - 1), h = (it >> 13) & 7, b = it >> 16;
        const size_t row = (size_t)b * S + q; const int own = q >> 8;
        qs[lane] = bf2f(qa[row * AW + h * HD + lane]);
        __builtin_amdgcn_s_waitcnt(0xc07f); asm volatile("" ::: "memory");
        float gate = -INFINITY;
        if (lane < own) { const float* kp = km + ((size_t)(b * AH + h) * NBLK + lane) * HD; float s = 0.f; for (int d = 0; d < HD; ++d) s += qs[d] * kp[d]; gate = s; }
        int s0 = 0, s1 = 0, s2 = 0; const int nsel = own < 3 ? own : 3;
#pragma unroll
        for (int i = 0; i < 3; ++i) { if (i < nsel) { const float mx = wave_max(gate); const unsigned long long bal = __ballot(gate == mx); const int w = __builtin_ctzll(bal); if (i == 0) s0 = w; else if (i == 1) s1 = w; else s2 = w; if (lane == w) gate = -INFINITY; } }
        float mx = -INFINITY;
        for (int sl = 0; sl <= nsel; ++sl) {
            const int blk = sl < nsel ? (sl == 0 ? s0 : sl == 1 ? s1 : s2) : own; const int cnt = sl < nsel ? MB : (q & 255) + 1;
            for (int kk = lane; kk < cnt; kk += 64) { const bf16x8* kp = (const bf16x8*)(ka + ((size_t)b * S + blk * MB + kk) * AW + h * HD); float s = 0.f;
#pragma unroll
                for (int j = 0; j < 8; ++j) { const bf16x8 kv = kp[j];
#pragma unroll
                    for (int e = 0; e < 8; ++e) s += qs[8 * j + e] * bf2f((unsigned short)kv[e]); }
                ps[sl * 256 + kk] = s; mx = fmaxf(mx, s); }
        }
        mx = wave_max(mx);
        __builtin_amdgcn_s_waitcnt(0xc07f); asm volatile("" ::: "memory");
        float l = 0.f, o = 0.f;
        for (int sl = 0; sl <= nsel; ++sl) {
            const int blk = sl < nsel ? (sl == 0 ? s0 : sl == 1 ? s1 : s2) : own; const int cnt = sl < nsel ? MB : (q & 255) + 1;
            const bf16* vp = va + ((size_t)b * S + blk * MB) * AW + h * HD + lane;
            for (int kk = 0; kk < cnt; ++kk) { const float p = exp2f(ps[sl * 256 + kk] - mx); l += p; o += p * bf2f(vp[(size_t)kk * AW]); }
        }
        mixed[row * D + h * HD + lane] = (bf16)f2bf(o / l);
        __builtin_amdgcn_s_waitcnt(0xc07f); asm volatile("" ::: "memory");
    }
}

__device__ __forceinline__ void mlstm_a(const Ctx& c, int layer) {
    const bf16* xn = (const bf16*)(c.ws + WS_XN); const bf16* WinT = (const bf16*)(c.ws + WS_W + (size_t)layer * W_LAYER + W_IN);
    const bf16* mkT = (const bf16*)(c.ws + WS_BIG + B_MKT); const bf16* mvT = (const bf16*)(c.ws + WS_BIG + B_MVT);
    float* igG = (float*)(c.ws + WS_IG); float* lfG = (float*)(c.ws + WS_LF); float* blast = (float*)(c.ws + WS_BLAST); float* mloc = (float*)(c.ws + WS_MLOC);
    float* nloc = (float*)(c.ws + WS_NLOC); float* UT = (float*)(c.ws + WS_BIG + B_UT);
    float* igs = (float*)c.lds; float* lfs = igs + 64; float* wgs = lfs + 64;
    for (int it = c.bid; it < NB * MH * NCH; it += c.G) {
        const int ch = it & (NCH - 1), bh = it >> 7, h = bh & 3, b = bh >> 2;
        for (int p = c.wave * 16; p < c.wave * 16 + 16; ++p) {
            const int t = p & 63, which = p >> 6;
            const bf16x8* xr = (const bf16x8*)(xn + ((size_t)b * S + ch * LCH + t) * D) + 2 * c.lane; const bf16x8* wr = (const bf16x8*)(WinT + (size_t)(NIN + which * 4 + h) * D) + 2 * c.lane;
            float s = 0.f;
#pragma unroll
            for (int j = 0; j < 2; ++j) { const bf16x8 xv = xr[j], wv = wr[j];
#pragma unroll
                for (int e = 0; e < 8; ++e) s += bf2f((unsigned short)xv[e]) * bf2f((unsigned short)wv[e]); }
            s = wave_sum(s);
            if (c.lane == 0) { if (which == 0) igs[t] = s + c.b_ig[layer * MH + h]; else { const float f = s + c.b_fg[layer * MH + h]; lfs[t] = fminf(f, 0.f) - log1pf(expf(-fabsf(f))); } }
        }
        __syncthreads();
        if (c.tid < 64) { igG[(size_t)bh * S + ch * LCH + c.tid] = igs[c.tid]; lfG[(size_t)bh * S + ch * LCH + c.tid] = lfs[c.tid]; }
        if (c.tid == 0) {
            float bl = 0.f; for (int s = 0; s < LCH; ++s) bl += lfs[s];
            float run = 0.f, mx = -INFINITY;
            for (int s = 0; s < LCH; ++s) { run += lfs[s]; const float g = bl - run + igs[s]; wgs[s] = g; mx = fmaxf(mx, g); }
            for (int s = 0; s < LCH; ++s) wgs[s] = expf(wgs[s] - mx);
            blast[it] = bl; mloc[it] = mx;
        }
        __syncthreads();
        for (int o = c.tid; o < DV * DK; o += NT) {
            const int dv = o >> 6, dk = o & 63;
            const bf16* vp = mvT + ((size_t)bh * DV + dv) * S + ch * LCH; const bf16* kp = mkT + ((size_t)bh * DK + dk) * S + ch * LCH; float s = 0.f;
            for (int t = 0; t < LCH; ++t) s += wgs[t] * bf2f(vp[t]) * bf2f(kp[t]);
            UT[((size_t)it * DV + dv) * DK + dk] = s;
        }
        if (c.tid < DK) { const bf16* kp = mkT + ((size_t)bh * DK + c.tid) * S + ch * LCH; float s = 0.f; for (int t = 0; t < LCH; ++t) s += wgs[t] * bf2f(kp[t]); nloc[(size_t)it * DK + c.tid] = s; }
        __syncthreads();
    }
}
__device__ __forceinline__ void mlstm_b(const Ctx& c) {
    const float* blast = (const float*)(c.ws + WS_BLAST); const float* mloc = (const float*)(c.ws + WS_MLOC); const float* nloc = (const float*)(c.ws + WS_NLOC);
    const float* UT = (const float*)(c.ws + WS_BIG + B_UT);
    float* mprev = (float*)(c.ws + WS_MPREV); float* nprev = (float*)(c.ws + WS_NPREV); bf16* CT = (bf16*)(c.ws + WS_XN);
    constexpr int EPB = DV * DK + DK;
    for (int e = c.bid * NT + c.tid; e < NB * MH * EPB; e += c.G * NT) {
        const int bh = e / EPB, r = e % EPB; const bool isC = r < DV * DK;
        float m = 0.f, val = 0.f;
#pragma unroll 4
        for (int ch = 0; ch < NCH; ++ch) {
            const int ci = bh * NCH + ch;
            const float u = isC ? UT[(size_t)ci * (DV * DK) + r] : nloc[(size_t)ci * DK + (r - DV * DK)];
            if (isC) CT[(size_t)ci * (DV * DK) + r] = (bf16)f2bf(val); else nprev[(size_t)ci * DK + (r - DV * DK)] = val;
            if (r == 0) mprev[ci] = m;
            const float bl = blast[ci], ml = mloc[ci];
            const float mn = fmaxf(bl + m, ml);
            val = expf(bl + m - mn) * val + expf(ml - mn) * u; m = mn;
        }
    }
}
__device__ __forceinline__ void mlstm_c_naive(const Ctx& c, int layer) {
    const bf16* mq = (const bf16*)(c.ws + WS_BIG + B_MQ); const bf16* mk = (const bf16*)(c.ws + WS_BIG + B_MK); const bf16* mvT = (const bf16*)(c.ws + WS_BIG + B_MVT);
    const bf16* mo = (const bf16*)(c.ws + WS_BIG + B_MO); const bf16* CT = (const bf16*)(c.ws + WS_XN);
    const float* igG = (const float*)(c.ws + WS_IG); const float* lfG = (const float*)(c.ws + WS_LF); const float* mprev = (const float*)(c.ws + WS_MPREV); const float* nprev = (const float*)(c.ws + WS_NPREV);
    bf16* mixed = (bf16*)(c.ws + WS_MIXED);
    float* qs = (float*)c.lds; float* ks = qs + 4096; float* Ss = ks + 4096; float* hs = Ss + 64 * 65; float* as = hs + 64 * 128; float* bs = as + 64; float* mt = bs + 64; float* dec = mt + 64; float* inv = dec + 64; float* rs = inv + 64;
    for (int it = c.bid; it < NB * MH * NCH; it += c.G) {
        const int ch = it & (NCH - 1), bh = it >> 7, h = bh & 3, b = bh >> 2;
        const size_t row0 = (size_t)b * S + ch * LCH;
        for (int i = c.tid; i < 4096; i += NT) { const int t = i >> 6, d = i & 63; qs[i] = bf2f(mq[(row0 + t) * 256 + h * DK + d]); ks[i] = bf2f(mk[(row0 + t) * 256 + h * DK + d]); }
        if (c.tid == 0) { float run = 0.f; for (int s = 0; s < LCH; ++s) { run += lfG[(size_t)bh * S + ch * LCH + s]; bs[s] = run; as[s] = igG[(size_t)bh * S + ch * LCH + s] - run; } }
        __syncthreads();
        const float mp = mprev[it];
        if (c.tid < 64) { float am = -INFINITY; for (int s = 0; s <= c.tid; ++s) am = fmaxf(am, as[s]); const float bt = bs[c.tid]; const float m = fmaxf(bt + mp, bt + am); mt[c.tid] = m; dec[c.tid] = expf(bt + mp - m); }
        __syncthreads();
        for (int i = c.tid; i < 4096; i += NT) { const int t = i >> 6, s = i & 63; float v = 0.f;
            if (s <= t) { float dt = 0.f; for (int d = 0; d < 64; ++d) dt += qs[t * 64 + d] * ks[s * 64 + d]; v = dt * expf(bs[t] + as[s] - mt[t]); }
            Ss[t * 65 + s] = v; }
        __syncthreads();
        if (c.tid < 64) { const int t = c.tid; float dn = 0.f; for (int s = 0; s < 64; ++s) dn += Ss[t * 65 + s]; float qn = 0.f; for (int d = 0; d < 64; ++d) qn += qs[t * 64 + d] * nprev[(size_t)it * DK + d];
            dn += dec[t] * qn; inv[t] = 1.0f / fmaxf(fabsf(dn), expf(-mt[t])); }
        __syncthreads();
        for (int i = c.tid; i < 64 * 128; i += NT) { const int t = i >> 7, dv = i & 127; float a = 0.f, cc = 0.f;
            const bf16* vp = mvT + ((size_t)bh * DV + dv) * S + ch * LCH; const bf16* cp = CT + (size_t)it * (DV * DK) + dv * DK;
            for (int s = 0; s < 64; ++s) a += Ss[t * 65 + s] * bf2f(vp[s]);
            for (int d = 0; d < 64; ++d) cc += qs[t * 64 + d] * bf2f(cp[d]);
            hs[i] = (a + dec[t] * cc) * inv[t]; }
        __syncthreads();
        if (c.tid < 64) { float s2 = 0.f; for (int dv = 0; dv < 128; ++dv) { const float v = hs[c.tid * 128 + dv]; s2 += v * v; } rs[c.tid] = 1.0f / sqrtf(s2 * (1.f / 128.f) + EPS); }
        __syncthreads();
        for (int i = c.tid; i < 64 * 128; i += NT) { const int t = i >> 7, dv = i & 127; const float g = c.g_mo[layer * 512 + h * DV + dv]; const float o = bf2f(mo[(row0 + t) * 512 + h * DV + dv]);
            mixed[(row0 + t) * D + 512 + h * DV + dv] = (bf16)f2bf(hs[i] * rs[t] * g / (1.0f + expf(-o))); }
        __syncthreads();
    }
}

__device__ __forceinline__ void rownorm_phase(const Ctx& c, const float* Y, int row0, int nrows, const float* base, const float* g1, const float* g2) {
    bf16* xn = (bf16*)(c.ws + WS_XN);
    for (int m = c.bid * NW + c.wave; m < nrows; m += c.G * NW) {
        const int row = row0 + m;
        const f32x4* yr = (const f32x4*)(Y + (size_t)m * D) + c.lane; const f32x4* br = (const f32x4*)(base + (size_t)row * D) + c.lane; const f32x4* g1r = (const f32x4*)g1 + c.lane;
        f32x4 v[4]; float s = 0.f;
#pragma unroll
        for (int j = 0; j < 4; ++j) { v[j] = yr[64 * j]; s += (v[j].x * v[j].x + v[j].y * v[j].y) + (v[j].z * v[j].z + v[j].w * v[j].w); }
        const float rstd = 1.0f / sqrtf(wave_sum(s) * (1.f / D) + EPS); float s1 = 0.f;
#pragma unroll
        for (int j = 0; j < 4; ++j) { v[j] = br[64 * j] + v[j] * rstd * g1r[64 * j]; s1 += (v[j].x * v[j].x + v[j].y * v[j].y) + (v[j].z * v[j].z + v[j].w * v[j].w); }
        f32x4* orow = (f32x4*)(c.out + (size_t)row * D) + c.lane;
#pragma unroll
        for (int j = 0; j < 4; ++j) orow[64 * j] = v[j];
        if (g2) { const float rstd1 = 1.0f / sqrtf(wave_sum(s1) * (1.f / D) + EPS); const f32x4* g2r = (const f32x4*)g2 + c.lane; u32x2* o8 = (u32x2*)(xn + (size_t)row * D) + c.lane;
#pragma unroll
            for (int j = 0; j < 4; ++j) { const f32x4 gg = g2r[64 * j]; u32x2 w; w.x = pk2(v[j].x * rstd1 * gg.x, v[j].y * rstd1 * gg.y); w.y = pk2(v[j].z * rstd1 * gg.z, v[j].w * rstd1 * gg.w); o8[64 * j] = w; } }
    }
}

constexpr int PH_PER_LAYER = 12, N_PHASES = 1 + NL * PH_PER_LAYER;
constexpr int LDS_BYTES = 147456;

__global__ void __launch_bounds__(NT, 2) fwd_kernel(Args args) {
    extern __shared__ __attribute__((aligned(16))) unsigned char lds[];
    Ctx c;
    c.lds = lds; c.tid = threadIdx.x; c.lane = c.tid & 63; c.wave = __builtin_amdgcn_readfirstlane(c.tid >> 6); c.G = gridDim.x; c.bid = blockIdx.x;
    c.x = (const float*)args.in[0]; c.pos = (const int*)args.in[1]; c.g_mix_pre = (const float*)args.in[2]; c.w_in = (const float*)args.in[3]; c.b_ig = (const float*)args.in[4];
    c.b_fg = (const float*)args.in[5]; c.g_mo = (const float*)args.in[6]; c.w_out = (const float*)args.in[7]; c.g_mix_post = (const float*)args.in[8]; c.g_mlp_pre = (const float*)args.in[9];
    c.w_up = (const float*)args.in[10]; c.w_dn = (const float*)args.in[11]; c.g_mlp_post = (const float*)args.in[12]; c.out = args.out; c.ws = args.ws;
    unsigned char* big = c.ws + WS_BIG;
    for (int ph = args.ph_lo; ph < args.ph_hi; ++ph) {
        if (ph == 0) p0_prologue(c);
        else {
            const int l = (ph - 1) / PH_PER_LAYER, p = (ph - 1) % PH_PER_LAYER;
            unsigned char* wl = c.ws + WS_W + (size_t)l * W_LAYER;
            const float* base = l == 0 ? c.x : c.out;
            switch (p) {
            case 0: { EpiInProj e{big, (const float*)(c.ws + WS_COS), (const float*)(c.ws + WS_SIN)}; gemm_naive(c, (const bf16*)(c.ws + WS_XN), D, (const bf16*)(wl + W_IN), D, 0, M, NIN, e); } break;
            case 1: kmean_phase(c); break;
            case 2: mlstm_a(c, l); break;
            case 3: mlstm_b(c); break;
            case 4: attn_naive(c); __syncthreads(); mlstm_c_naive(c, l); break;
            case 5: { EpiF32Out e{(float*)big, D, 0}; gemm_naive(c, (const bf16*)(c.ws + WS_MIXED), D, (const bf16*)(wl + W_OUT), D, 0, M, D, e); } break;
            case 6: rownorm_phase(c, (const float*)big, 0, M, base, c.g_mix_post + l * D, c.g_mlp_pre + l * D); break;
            case 7: { EpiRelu2 e{(bf16*)big}; gemm_naive(c, (const bf16*)(c.ws + WS_XN), D, (const bf16*)(wl + W_UP), D, 0, M, FF, e); } break;
            case 8: case 10: { const int r0 = (p == 8) ? 0 : M / 2; EpiF32Out e{(float*)(c.ws + WS_MIXED), D, r0}; gemm_naive(c, (const bf16*)big, FF, (const bf16*)(wl + W_DN), FF, r0, M / 2, D, e); } break;
            case 9: case 11: { const int r0 = (p == 9) ? 0 : M / 2; rownorm_phase(c, (const float*)(c.ws + WS_MIXED), r0, M / 2, c.out, c.g_mlp_post + l * D, (l + 1 < NL) ? c.g_mix_pre + (l + 1) * D : nullptr); } break;
            }
        }
        if (ph + 1 < args.ph_hi) { cg::this_grid().sync(); }
    }
}

extern "C" void kernel_launch(void* const* d_in, const int* in_sizes, int n_in, void* d_out, int out_size, void* d_ws, size_t ws_size, hipStream_t stream) {
    static int grid = 0;
    if (grid == 0) {
        if (n_in != 13 || out_size != M * D || ws_size < WS_END) { fprintf(stderr, "kernel_launch: unexpected shapes (n_in %d out %d ws %zu)\n", n_in, out_size, ws_size); grid = -1; return; }
        int dev = 0, cus = 0, per_cu = 0;
        (void)hipGetDevice(&dev); (void)hipDeviceGetAttribute(&cus, hipDeviceAttributeMultiprocessorCount, dev);
        (void)hipFuncSetAttribute((const void*)fwd_kernel, hipFuncAttributeMaxDynamicSharedMemorySize, LDS_BYTES);
        (void)hipOccupancyMaxActiveBlocksPerMultiprocessor(&per_cu, (const void*)fwd_kernel, NT, LDS_BYTES);
        if (per_cu < 1) { fprintf(stderr, "kernel_launch: occupancy query says %d blocks per CU\n", per_cu); }
        (void)hipGetLastError();
        grid = cus > 0 ? cus : 256;
    }
    if (grid < 0) return;
    (void)hipMemsetAsync((char*)d_ws + WS_CTL, 0, CTL_BYTES, stream);
    Args a{};
    for (int i = 0; i < 13; ++i) a.in[i] = d_in[i];
    a.out = (float*)d_out; a.ws = (unsigned char*)d_ws;
#if MK_SINGLE
    a.ph_lo = 0; a.ph_hi = N_PHASES;
    void* kargs[] = {&a};
    hipError_t e = hipLaunchCooperativeKernel((const void*)fwd_kernel, dim3(grid), dim3(NT), kargs, LDS_BYTES, stream);
    if (e != hipSuccess) fprintf(stderr, "cooperative launch failed: %s (grid %d)\n", hipGetErrorString(e), grid);
#else
    for (int ph = 0; ph < N_PHASES; ++ph) { a.ph_lo = ph; a.ph_hi = ph + 1; hipLaunchKernelGGL(fwd_kernel, dim3(grid), dim3(NT), LDS_BYTES, stream, a); }
#endif
}
```
